# Optimizing an MI355X kernel written in HIP

```python
import jax, jax.numpy as jnp
from jax import lax
import numpy as np

D_MODEL = 1024
BATCH = 4
SEQ = 4096
DEPTH = 1
DEC_BATCH = 128
DEC_SEQ = 8
PAST_LEN = 8192
PAGE_SIZE = 128

D_MIX = D_MODEL
HEAD_DIM = 64
N_HEADS_ATT = (D_MIX // 2) // HEAD_DIM
D_ATT = N_HEADS_ATT * HEAD_DIM
DILATED_PATTERNS = ((128, 1), (512, 4), (2048, 16))
WINDOW_MAX = 2048
ATT_BLOCK = 128
ROT_DIM = HEAD_DIM // 4
ROPE_THETA = 500000.0
N_HEADS_GLA = 4
D_GLA_V = D_MIX - D_ATT
D_GLA_K = D_GLA_V // 2
GLA_DK = D_GLA_K // N_HEADS_GLA
GLA_DV = D_GLA_V // N_HEADS_GLA
GLA_GATE_RANK = 16
GLA_TAU = 16.0
GLA_CHUNK = 16
EPS = 1e-6
IN_SPLITS = (D_ATT, D_ATT, D_ATT, D_ATT, D_GLA_K, D_GLA_K, D_GLA_V, D_GLA_V, GLA_GATE_RANK)
D_IN = sum(IN_SPLITS)

kernel_name = "hymba_dilated_gla_decode_step"


def rms_norm(x, g):
    xf = x.astype(jnp.float32)
    y = xf * lax.rsqrt(jnp.mean(xf * xf, axis=-1, keepdims=True) + EPS)
    return (y * g.astype(jnp.float32)).astype(x.dtype)


def rotary(x, pos):
    half = ROT_DIM // 2
    inv = 1.0 / (ROPE_THETA ** (jnp.arange(half, dtype=jnp.float32) / half))
    ang = pos.astype(jnp.float32)[:, None] * inv[None, :]
    cos = jnp.cos(ang)[None, :, None, :]
    sin = jnp.sin(ang)[None, :, None, :]
    xr = x[..., :ROT_DIM].astype(jnp.float32)
    x1, x2 = xr[..., :half], xr[..., half:]
    rot = jnp.concatenate([x1 * cos - x2 * sin, x2 * cos + x1 * sin], axis=-1)
    return jnp.concatenate([rot.astype(x.dtype), x[..., ROT_DIM:]], axis=-1)


def dilated_prompt(q, k, v, dil, steps):
    B, S, H, hd = q.shape
    L = S // dil
    nb = -(-L // ATT_BLOCK)
    Lp = nb * ATT_BLOCK

    def blocks(t):
        t = t.astype(jnp.float32).reshape(B, L, dil, H, hd)
        t = jnp.pad(t, ((0, 0), (0, Lp - L), (0, 0), (0, 0), (0, 0)))
        return t.reshape(B, nb, ATT_BLOCK, dil, H, hd)

    def with_prev(t):
        prev = jnp.pad(t, ((0, 0), (1, 0), (0, 0), (0, 0), (0, 0), (0, 0)))[:, :-1]
        return jnp.concatenate([prev, t], axis=2)

    qb = blocks(q)
    kk = with_prev(blocks(k))
    vv = with_prev(blocks(v))
    s = jnp.einsum('bnqrhd,bnkrhd->bnrhqk', qb, kk) * (hd ** -0.5)
    n_idx = jnp.arange(nb)[:, None]
    qpos = n_idx * ATT_BLOCK + jnp.arange(ATT_BLOCK)[None, :]
    kpos = n_idx * ATT_BLOCK - ATT_BLOCK + jnp.arange(2 * ATT_BLOCK)[None, :]
    dist = qpos[:, :, None] - kpos[:, None, :]
    mask = (dist >= 0) & (dist <= steps) & (kpos[:, None, :] >= 0)
    s = jnp.where(mask[None, :, None, None], s, -jnp.inf)
    lse = jax.nn.logsumexp(s, axis=-1)
    p = jnp.exp(s - lse[..., None])
    o = jnp.einsum('bnrhqk,bnkrhd->bnqrhd', p, vv)
    o = o.reshape(B, Lp, dil, H, hd)[:, :L].reshape(B, S, H, hd)
    lse = lse.transpose(0, 1, 4, 2, 3).reshape(B, Lp, dil, H)[:, :L].reshape(B, S, H)
    return o, lse


def dilated_sample(q, kall, vall, dil, steps):
    B, T, H, hd = q.shape
    W = kall.shape[1] - T
    idx = W + jnp.arange(T)[:, None] - jnp.arange(steps + 1)[None, :] * dil
    valid = idx >= 0
    idxc = jnp.maximum(idx, 0)
    kg = jnp.take(kall, idxc, axis=1).astype(jnp.float32)
    vg = jnp.take(vall, idxc, axis=1).astype(jnp.float32)
    s = jnp.einsum('bthd,btjhd->bthj', q.astype(jnp.float32), kg) * (hd ** -0.5)
    s = jnp.where(valid[None, :, None, :], s, -jnp.inf)
    lse = jax.nn.logsumexp(s, axis=-1)
    p = jnp.exp(s - lse[..., None])
    o = jnp.einsum('bthj,btjhd->bthd', p, vg)
    return o, lse


def merge_by_denominator(outs, lses):
    w = jax.nn.softmax(jnp.stack(lses, axis=0), axis=0)
    return jnp.sum(w[..., None] * jnp.stack(outs, axis=0), axis=0)


def gla_chunked(q, k, v, log_a, s0):
    B, T, H, dk = q.shape
    dv = v.shape[-1]
    C = GLA_CHUNK
    N = -(-T // C)
    Tp = N * C

    def prep(t):
        t = jnp.pad(t.astype(jnp.float32), ((0, 0), (0, Tp - T), (0, 0), (0, 0)))
        return t.reshape(B, N, C, H, -1).transpose(1, 0, 3, 2, 4)

    q, k, v, la = prep(q), prep(k), prep(v), prep(log_a)
    b = jnp.cumsum(la, axis=3)
    causal = jnp.tril(jnp.ones((C, C), dtype=bool))
    diff = b[:, :, :, :, None, :] - b[:, :, :, None, :, :]
    decay = jnp.exp(jnp.where(causal[:, :, None], diff, -jnp.inf))
    A = jnp.einsum('nbhtc,nbhsc,nbhtsc->nbhts', q, k, decay)
    o_intra = jnp.einsum('nbhts,nbhsv->nbhtv', A, v)
    b_last = b[:, :, :, -1:, :]
    q_in = q * jnp.exp(b)
    k_in = k * jnp.exp(b_last - b)
    a_last = jnp.exp(b_last[:, :, :, 0, :])

    def step(S, xs):
        qi, ki, vi, ai = xs
        o = jnp.einsum('bhtk,bhkv->bhtv', qi, S)
        S = ai[..., None] * S + jnp.einsum('bhtk,bhtv->bhkv', ki, vi)
        return S, o

    S, o_inter = lax.scan(step, s0.astype(jnp.float32), (q_in, k_in, v, a_last))
    o = (o_intra + o_inter).transpose(1, 0, 3, 2, 4).reshape(B, Tp, H, dv)[:, :T]
    return o, S


def project(x, c, w_mod, b_mod, g_pre, w_in, w_a2, b_a2):
    B, T, _ = x.shape
    mod = jax.nn.silu(c) @ w_mod + b_mod
    shift, scale, gate = jnp.split(mod, 3, axis=-1)
    h = rms_norm(x, g_pre) * (1 + scale[:, None, :]) + shift[:, None, :]
    z = h @ w_in
    offsets = np.cumsum(IN_SPLITS)[:-1].tolist()
    q_a, k_a, v_a, g_a, q_g, k_g, v_g, g_g, a_lr = jnp.split(z, offsets, axis=-1)
    ha = lambda t: t.reshape(B, T, N_HEADS_ATT, HEAD_DIM)
    hk = lambda t: t.reshape(B, T, N_HEADS_GLA, GLA_DK)
    log_a = jax.nn.log_sigmoid((a_lr @ w_a2 + b_a2).astype(jnp.float32)) / GLA_TAU
    return (gate, ha(q_a), ha(k_a), ha(v_a), g_a,
            hk(q_g), hk(k_g), v_g.reshape(B, T, N_HEADS_GLA, GLA_DV), g_g, hk(log_a))


def finish(x, gate, o_att, g_a, o_gla, g_g, g_gla, g_post, w_out):
    B, T, _ = x.shape
    o_gla = rms_norm(o_gla, g_gla)
    att = o_att.reshape(B, T, D_ATT).astype(x.dtype) * jax.nn.silu(g_a)
    gla = o_gla.reshape(B, T, D_GLA_V).astype(x.dtype) * jax.nn.silu(g_g)
    y = rms_norm(jnp.concatenate([att, gla], axis=-1) @ w_out, g_post)
    return x + gate[:, None, :] * y


def setup_inputs(seed: int = 0) -> dict:
    key = jax.random.key(seed)
    ks = jax.random.split(key, 16)
    wbuf = min(WINDOW_MAX, PAST_LEN)
    f32 = jnp.float32
    nrm = lambda k, shape, s: jax.random.normal(k, shape, f32) * s
    return {
        "x_prompt": nrm(ks[0], (BATCH, SEQ, D_MODEL), 1.0),
        "x_sample": nrm(ks[1], (DEC_BATCH, DEC_SEQ, D_MODEL), 1.0),
        "c_prompt": nrm(ks[2], (BATCH, D_MODEL), 1.0),
        "c_sample": nrm(ks[3], (DEC_BATCH, D_MODEL), 1.0),
        "cache_k_win": nrm(ks[4], (DEC_BATCH, wbuf, N_HEADS_ATT, HEAD_DIM), 1.0),
        "cache_v_win": nrm(ks[5], (DEC_BATCH, wbuf, N_HEADS_ATT, HEAD_DIM), 1.0),
        "state_gla": nrm(ks[6], (DEC_BATCH, N_HEADS_GLA, GLA_DK, GLA_DV), 0.5),
        "w_mod": nrm(ks[7], (D_MODEL, 3 * D_MODEL), 0.5 * D_MODEL ** -0.5),
        "b_mod": nrm(ks[8], (3 * D_MODEL,), 0.02),
        "g_pre": 1.0 + nrm(ks[9], (D_MODEL,), 0.02),
        "g_post": 1.0 + nrm(ks[10], (D_MODEL,), 0.02),
        "w_in": nrm(ks[11], (D_MODEL, D_IN), D_MODEL ** -0.5),
        "w_a2": nrm(ks[12], (GLA_GATE_RANK, D_GLA_K), GLA_GATE_RANK ** -0.5),
        "b_a2": nrm(ks[13], (D_GLA_K,), 0.1),
        "g_gla": 1.0 + nrm(ks[14], (GLA_DV,), 0.02),
        "w_out": nrm(ks[15], (D_MIX, D_MODEL), D_MIX ** -0.5),
    }


def reference(x_prompt, x_sample, c_prompt, c_sample, cache_k_win, cache_v_win, state_gla,
              w_mod, b_mod, g_pre, g_post, w_in, w_a2, b_a2, g_gla, w_out):
    S = x_prompt.shape[1]
    pos_p = jnp.arange(S)
    y_prompt = x_prompt
    y_sample = x_sample
    for _layer in range(DEPTH):
        gate, q_a, k_a, v_a, g_a, q_g, k_g, v_g, g_g, log_a = project(
            y_prompt, c_prompt, w_mod, b_mod, g_pre, w_in, w_a2, b_a2)
        q_a = rotary(q_a, pos_p)
        k_a = rotary(k_a, pos_p)
        res = [dilated_prompt(q_a, k_a, v_a, d, w // d) for (w, d) in DILATED_PATTERNS]
        o_att = merge_by_denominator([r[0] for r in res], [r[1] for r in res])
        s0 = jnp.zeros((y_prompt.shape[0], N_HEADS_GLA, GLA_DK, GLA_DV), jnp.float32)
        o_gla, gla_p = gla_chunked(q_g * (GLA_DK ** -0.5), k_g, v_g, log_a, s0)
        y_prompt = finish(y_prompt, gate, o_att, g_a, o_gla, g_g, g_gla, g_post, w_out)
        wp = min(WINDOW_MAX, S)
        k_win_prompt = k_a[:, S - wp:]
        v_win_prompt = v_a[:, S - wp:]
        gla_prompt = gla_p.astype(x_prompt.dtype)

        T = x_sample.shape[1]
        W = cache_k_win.shape[1]
        pos_s = PAST_LEN + jnp.arange(T)
        gate, q_a, k_a, v_a, g_a, q_g, k_g, v_g, g_g, log_a = project(
            y_sample, c_sample, w_mod, b_mod, g_pre, w_in, w_a2, b_a2)
        q_a = rotary(q_a, pos_s)
        k_a = rotary(k_a, pos_s)
        kall = jnp.concatenate([cache_k_win, k_a.astype(cache_k_win.dtype)], axis=1)
        vall = jnp.concatenate([cache_v_win, v_a.astype(cache_v_win.dtype)], axis=1)
        res = [dilated_sample(q_a, kall, vall, d, w // d) for (w, d) in DILATED_PATTERNS]
        o_att = merge_by_denominator([r[0] for r in res], [r[1] for r in res])
        o_gla, gla_s = gla_chunked(q_g * (GLA_DK ** -0.5), k_g, v_g, log_a, state_gla)
        y_sample = finish(y_sample, gate, o_att, g_a, o_gla, g_g, g_gla, g_post, w_out)
        k_win_sample = kall[:, T:T + W]
        v_win_sample = vall[:, T:T + W]
        gla_sample = gla_s.astype(state_gla.dtype)
    return (y_prompt, y_sample, k_win_prompt, v_win_prompt, gla_prompt,
            k_win_sample, v_win_sample, gla_sample)
```

```cpp
#include <hip/hip_runtime.h>
#include <cstdio>
#include <cstdint>
namespace pg8 {
#define PG8_LAS __attribute__((address_space(3)))
typedef unsigned short bf16_t;
typedef short bf16x8 __attribute__((ext_vector_type(8)));
typedef float f32x4 __attribute__((ext_vector_type(4)));
typedef unsigned u32x4 __attribute__((ext_vector_type(4)));
constexpr int BM = 256, BK = 64, HALF = 128, HTB = HALF * BK * 2  , STAGE_BYTES = 8 * HTB, NXCD = 8, WGM = 8;

__host__ __device__ __forceinline__ int lds_byte(int r, int c) { const int st = (r >> 4) * 2 + (c >> 5), rr = r & 15, cc = c & 31, ob = rr * 64 + cc * 2; return st * 1024 + (ob ^ (((ob >> 9) & 1) << 5)); }
__host__ __device__ __forceinline__ void stage_rc(int b, int& R, int& C) { const int st = b / 1024, sb = b % 1024, swz = sb ^ (((sb >> 9) & 1) << 5); R = (st >> 1) * 16 + swz / 64; C = (st & 1) * 32 + (swz % 64) / 2; }
__host__ __device__ __forceinline__ int perm32(int rho) { const int n = rho >> 4, i = rho & 15; return 8 * (i >> 2) + 4 * n + (i & 3); }

struct Unit { int pm, pn; };
struct Gemm { const bf16_t* A; const bf16_t* Bt; int M, N, K; };

struct StaticOrder {
    int nM, nN, nwg, G, c;
    __host__ __device__ void init(int M, int N, int G_, int c_) { nM = M / BM; nN = N / BM; nwg = nM * nN; G = G_; c = c_; }
    __host__ __device__ bool next(int i, Unit& u) const {
        const long L = (long)i * G + c; if (L >= nwg) return false;
        int wgid = (int)L; { const int q = nwg / NXCD, r = nwg % NXCD, xcd = wgid % NXCD, off = wgid / NXCD; wgid = (xcd < r ? xcd * (q + 1) : r * (q + 1) + (xcd - r) * q) + off; }
        const int nig = WGM * nN, gid = wgid / nig, fm = gid * WGM, gsz = (nM - fm) < WGM ? (nM - fm) : WGM;
        u.pm = fm + ((wgid % nig) % gsz); u.pn = (wgid % nig) / gsz; return true;
    }
    __device__ __forceinline__ void a_ready(const Unit&) const {}
    __device__ __forceinline__ void done(const Unit&) const {}
};

__device__ __forceinline__ unsigned cvt_pk_bf16(float lo, float hi) { unsigned r; asm volatile("v_cvt_pk_bf16_f32 %0, %1, %2" : "=v"(r) : "v"(lo), "v"(hi)); return r; }
typedef float f32x2 __attribute__((ext_vector_type(2)));


template <class Epi, class Sched, bool ALIGN_EPI = false, bool SP2 = false>
__device__ __forceinline__ void gemm_phase(PG8_LAS unsigned char* lds, const Gemm g, const Sched& S, const Epi& E) {
    const int tid = threadIdx.x, wid = __builtin_amdgcn_readfirstlane(tid >> 6), lane = tid & 63, wr = wid >> 2, wc = wid & 3, fr = lane & 15, fq = lane >> 4;
    const int K = g.K, nt = K / BK;
    unsigned voffA[2], voffB[2];
#pragma unroll
    for (int i = 0; i < 2; ++i) { int R, C; stage_rc(tid * 16 + i * 8192, R, C); const int Rb = Epi::PERM ? ((R & ~31) + perm32(R & 31)) : R;
        voffA[i] = (unsigned)(R * K + C) * 2u; voffB[i] = (unsigned)(Rb * K + C) * 2u; }
    const size_t kstep = (size_t)(BK * 2);
    const size_t hstep = (size_t)HALF * K * 2;
    const size_t tstep = 2 * hstep;
    const unsigned ldsw = (unsigned)wid * 1024u;
    const int aoff = lds_byte(wr * 64 + fr, fq * 8), boff = lds_byte(wc * 32 + fr, fq * 8);
#define PG8_SA(b, h) (((b) * 2 + (h)) * HTB)
#define PG8_SB(b, h) ((4 + (b) * 2 + (h)) * HTB)
#define PG8_STAGE(bufoff, gbase, voff) do { _Pragma("unroll") for (int _i = 0; _i < 2; ++_i) \
        __builtin_amdgcn_global_load_lds((const unsigned*)((const char*)(gbase) + (voff)[_i]), (PG8_LAS unsigned*)(lds + (bufoff) + ldsw + _i * 8192), 16, 0, 0); } while (0)
#define PG8_LDA(dst, b, h) do { _Pragma("unroll") for (int m = 0; m < 4; ++m) _Pragma("unroll") for (int k = 0; k < 2; ++k) dst[m][k] = *(const PG8_LAS bf16x8*)(lds + PG8_SA(b, h) + aoff + m * 2048 + k * 1024); } while (0)
#define PG8_LDB(dst, b, h) do { _Pragma("unroll") for (int n = 0; n < 2; ++n) _Pragma("unroll") for (int k = 0; k < 2; ++k) dst[n][k] = *(const PG8_LAS bf16x8*)(lds + PG8_SB(b, h) + boff + n * 2048 + k * 1024); } while (0)
#define PG8_MMA(ai, bj, At, Bt) do { __builtin_amdgcn_s_setprio(1); _Pragma("unroll") for (int m = 0; m < 4; ++m) _Pragma("unroll") for (int n = 0; n < 2; ++n) _Pragma("unroll") for (int k = 0; k < 2; ++k) \
        acc[ai][bj][m][n] = __builtin_amdgcn_mfma_f32_16x16x32_bf16(Bt[n][k], At[m][k], acc[ai][bj][m][n], 0, 0, 0); __builtin_amdgcn_s_setprio(0); } while (0)
#define PG8_WAIT_V(n) asm volatile("s_waitcnt vmcnt(" #n ")" ::: "memory")
#define PG8_WAIT_L(n) asm volatile("s_waitcnt lgkmcnt(" #n ")" ::: "memory")
#define PG8_BAR __builtin_amdgcn_s_barrier()
#define PG8_SCHED __builtin_amdgcn_sched_barrier(0)
    Unit cur, nxt; int ui = 0;
    if (!S.next(0, cur)) return;
    f32x4 acc[2][2][4][2];
#pragma unroll
    for (int a = 0; a < 2; ++a)
#pragma unroll
        for (int b = 0; b < 2; ++b)
#pragma unroll
            for (int m = 0; m < 4; ++m)
#pragma unroll
                for (int n = 0; n < 2; ++n) acc[a][b][m][n] = (f32x4){0.f, 0.f, 0.f, 0.f};
    bf16x8 At[4][2], B0[2][2], B1[2][2];
    const char* cA = (const char*)g.A + (size_t)cur.pm * tstep; const char* cB = (const char*)g.Bt + (size_t)cur.pn * tstep;
    S.a_ready(cur);
    if constexpr (SP2) {
        PG8_STAGE(PG8_SB(0, 0), cB, voffB); PG8_STAGE(PG8_SB(0, 1), cB + hstep, voffB); PG8_STAGE(PG8_SA(0, 0), cA, voffA); PG8_STAGE(PG8_SA(0, 1), cA + hstep, voffA);
        if (wr == 1) PG8_BAR;
        PG8_WAIT_V(2); PG8_BAR;
        PG8_STAGE(PG8_SB(1, 0), cB + kstep, voffB); PG8_STAGE(PG8_SA(1, 0), cA + kstep, voffA); PG8_STAGE(PG8_SB(1, 1), cB + hstep + kstep, voffB);
        PG8_WAIT_V(6); PG8_BAR;
    } else {
        PG8_STAGE(PG8_SB(0, 0), cB, voffB); PG8_STAGE(PG8_SA(0, 0), cA, voffA); PG8_STAGE(PG8_SB(0, 1), cB + hstep, voffB); PG8_STAGE(PG8_SA(0, 1), cA + hstep, voffA);
        if (wr == 1) PG8_BAR;
        PG8_WAIT_V(4); PG8_BAR;
        PG8_STAGE(PG8_SB(1, 0), cB + kstep, voffB); PG8_STAGE(PG8_SA(1, 0), cA + kstep, voffA); PG8_STAGE(PG8_SB(1, 1), cB + hstep + kstep, voffB);
        PG8_WAIT_V(6); PG8_BAR;
    }
    for (;;) {
        const bool has_next = S.next(ui + 1, nxt);
        const char* nA = has_next ? (const char*)g.A + (size_t)nxt.pm * tstep : cA; const char* nB = has_next ? (const char*)g.Bt + (size_t)nxt.pn * tstep : cB;
        for (int t = 0; t < nt; t += 2) {
            const bool last = (t == nt - 2);
            const char* a1 = cA + (size_t)(t + 1) * kstep;
            const char* a2 = last ? nA : cA + (size_t)(t + 2) * kstep; const char* b2 = last ? nB : cB + (size_t)(t + 2) * kstep;
            const char* a3 = a2 + kstep; const char* b3 = b2 + kstep;
            if (last && has_next) S.a_ready(nxt);
            if constexpr (SP2) {
            PG8_LDB(B0, 0, 0); PG8_LDB(B1, 0, 1); PG8_SCHED; PG8_LDA(At, 0, 0); PG8_STAGE(PG8_SA(1, 1), a1 + hstep, voffA);
            PG8_WAIT_V(8); PG8_WAIT_L(0); PG8_BAR; PG8_MMA(0, 0, At, B0); PG8_MMA(0, 1, At, B1); PG8_BAR; PG8_SCHED;
            PG8_LDA(At, 0, 1); PG8_STAGE(PG8_SB(0, 0), b2, voffB); PG8_STAGE(PG8_SB(0, 1), b2 + hstep, voffB); PG8_STAGE(PG8_SA(0, 0), a2, voffA);
            PG8_WAIT_V(8); PG8_WAIT_L(0); PG8_BAR; PG8_MMA(1, 0, At, B0); PG8_MMA(1, 1, At, B1); PG8_BAR; PG8_SCHED;
            PG8_LDB(B0, 1, 0); PG8_LDB(B1, 1, 1); PG8_SCHED; PG8_LDA(At, 1, 0); PG8_STAGE(PG8_SA(0, 1), a2 + hstep, voffA);
            PG8_WAIT_V(8); PG8_WAIT_L(0); PG8_BAR; PG8_MMA(0, 0, At, B0); PG8_MMA(0, 1, At, B1); PG8_BAR; PG8_SCHED;
            PG8_LDA(At, 1, 1); PG8_STAGE(PG8_SB(1, 0), b3, voffB); PG8_STAGE(PG8_SB(1, 1), b3 + hstep, voffB); PG8_STAGE(PG8_SA(1, 0), a3, voffA);
            PG8_WAIT_V(8); PG8_WAIT_L(0); PG8_BAR; PG8_MMA(1, 0, At, B0); PG8_MMA(1, 1, At, B1); PG8_BAR; PG8_SCHED;
            } else {
            PG8_LDB(B0, 0, 0); PG8_SCHED; PG8_LDA(At, 0, 0); PG8_STAGE(PG8_SA(1, 1), a1 + hstep, voffA);
            PG8_WAIT_L(8); PG8_BAR; PG8_WAIT_L(0); PG8_MMA(0, 0, At, B0); PG8_BAR; PG8_SCHED;
            PG8_LDB(B1, 0, 1); PG8_STAGE(PG8_SB(0, 0), b2, voffB);
            PG8_BAR; PG8_WAIT_L(0); PG8_MMA(0, 1, At, B1); PG8_BAR;
            PG8_LDA(At, 0, 1); PG8_STAGE(PG8_SA(0, 0), a2, voffA);
            PG8_BAR; PG8_WAIT_L(0); PG8_MMA(1, 0, At, B0); PG8_BAR; PG8_SCHED;
            PG8_STAGE(PG8_SB(0, 1), b2 + hstep, voffB);
            PG8_WAIT_V(6); PG8_BAR; PG8_MMA(1, 1, At, B1); PG8_BAR;
            PG8_LDB(B0, 1, 0); PG8_SCHED; PG8_LDA(At, 1, 0); PG8_STAGE(PG8_SA(0, 1), a2 + hstep, voffA);
            PG8_WAIT_L(8); PG8_BAR; PG8_WAIT_L(0); PG8_MMA(0, 0, At, B0); PG8_BAR; PG8_SCHED;
            PG8_LDB(B1, 1, 1); PG8_STAGE(PG8_SB(1, 0), b3, voffB);
            PG8_BAR; PG8_WAIT_L(0); PG8_MMA(0, 1, At, B1); PG8_BAR;
            PG8_LDA(At, 1, 1); PG8_STAGE(PG8_SA(1, 0), a3, voffA);
            PG8_BAR; PG8_WAIT_L(0); PG8_MMA(1, 0, At, B0); PG8_BAR; PG8_SCHED;
            PG8_STAGE(PG8_SB(1, 1), b3 + hstep, voffB);
            PG8_WAIT_V(6); PG8_BAR; PG8_MMA(1, 1, At, B1); PG8_BAR;
            }
        }
        if constexpr (ALIGN_EPI) { if (wr == 0) PG8_BAR; }
        if constexpr (!Epi::AFTER_DRAIN) { E(acc, cur, wr, wc, fr, fq); S.done(cur); }
        if (!has_next) break;
#pragma unroll
        for (int a = 0; a < 2; ++a)
#pragma unroll
            for (int b = 0; b < 2; ++b)
#pragma unroll
                for (int m = 0; m < 4; ++m)
#pragma unroll
                    for (int n = 0; n < 2; ++n) acc[a][b][m][n] = (f32x4){0.f, 0.f, 0.f, 0.f};
        cur = nxt; cA = nA; cB = nB; ++ui;
        if constexpr (ALIGN_EPI) { if (wr == 1) PG8_BAR; }
    }
    PG8_WAIT_V(0);
    if constexpr (!ALIGN_EPI) { if (wr == 0) PG8_BAR; }
    PG8_BAR;
    if constexpr (Epi::AFTER_DRAIN) { E.fused(acc, cur, wr, wc, fr, fq, lds, wid, lane); S.done(cur); }
#undef PG8_SA
#undef PG8_SB
#undef PG8_STAGE
#undef PG8_LDA
#undef PG8_LDB
#undef PG8_MMA
#undef PG8_WAIT_V
#undef PG8_WAIT_L
#undef PG8_BAR
#undef PG8_SCHED
}
}

constexpr int NWAVES = 8, NTHR = NWAVES * 64;
constexpr int D = 1024, BP = 4, SP = 4096, BS = 128, TS = 8, WB = 2048;
constexpr int MP = BP * SP, MS = BS * TS, MROWS = MP + MS;
constexpr int DATT = 512, NZ = 3584, DIN = 3600;
constexpr int NMODROWS = BP + BS;
constexpr float EPSN = 1e-6f;
constexpr float QSCALE = 0.125f * 1.4426950408889634f;
constexpr int NGLA_UNITS = 16 * 64;

constexpr size_t O_YP = 0, O_YS = (size_t)MP * D, O_KWP = O_YS + (size_t)MS * D, O_VWP = O_KWP + (size_t)BP * WB * DATT,
                 O_GP = O_VWP + (size_t)BP * WB * DATT, O_KWS = O_GP + (size_t)BP * 4 * 64 * 128, O_VWS = O_KWS + (size_t)BS * WB * DATT,
                 O_GS = O_VWS + (size_t)BS * WB * DATT, O_END = O_GS + (size_t)BS * 4 * 64 * 128;

constexpr size_t MiB = 1u << 20;
constexpr size_t WS_CTL = 0, CTL_ZERO_BYTES = 1 * MiB;
constexpr size_t WS_WINT = 2 * MiB, WS_WOT = 10 * MiB, WS_MOD = 12 * MiB, WS_CS = 14 * MiB, WS_H = 16 * MiB, WS_LA = 52 * MiB;
constexpr size_t WS_QA = 72 * MiB, WS_KA = 90 * MiB, WS_VA = 108 * MiB, WS_GA = 126 * MiB, WS_QG = 144 * MiB, WS_KG = 154 * MiB, WS_VG = 164 * MiB, WS_GG = 182 * MiB;
constexpr size_t WS_QS = 200 * MiB, WS_MIX = 204 * MiB, WS_SLOC = 240 * MiB, WS_ACH = 272 * MiB, WS_SPREV = 274 * MiB, WS_Y = 292 * MiB, WS_END = 362 * MiB;
constexpr int CW_BAR = 4096;

constexpr int RING_BYTES = 131072, LDSCTL_OFF = RING_BYTES, MISC_OFF = LDSCTL_OFF + 320, LDS_BYTES = 147456;

#define GAS __attribute__((address_space(1)))
#define LAS __attribute__((address_space(3)))
typedef unsigned short bf16;
typedef unsigned v4u __attribute__((ext_vector_type(4)));
typedef unsigned v2u __attribute__((ext_vector_type(2)));
typedef float f32x4 __attribute__((ext_vector_type(4)));
typedef float f32x2 __attribute__((ext_vector_type(2)));
typedef short bf16x8 __attribute__((ext_vector_type(8)));
typedef short s16x4 __attribute__((ext_vector_type(4)));
typedef __bf16 bf16x2_t __attribute__((ext_vector_type(2)));
typedef GAS unsigned gu32;
#define RLX_AGENT __ATOMIC_RELAXED, __HIP_MEMORY_SCOPE_AGENT
#define LDS_WAIT() asm volatile("s_waitcnt lgkmcnt(0)" ::: "memory")
#define VM_WAIT() asm volatile("s_waitcnt vmcnt(0)" ::: "memory")

__device__ __forceinline__ unsigned pk2(float lo, float hi) { f32x2 v = {lo, hi}; bf16x2_t b = __builtin_convertvector(v, bf16x2_t); return __builtin_bit_cast(unsigned, b); }
__device__ __forceinline__ float bflo(unsigned w) { return __uint_as_float(w << 16); }
__device__ __forceinline__ float bfhi(unsigned w) { return __uint_as_float(w & 0xffff0000u); }
__device__ __forceinline__ float bf2f(bf16 b) { return __uint_as_float(((unsigned)b) << 16); }
__device__ __forceinline__ float wave_sum(float v) {
#pragma unroll
    for (int o = 1; o < 64; o <<= 1) v += __shfl_xor(v, o);
    return v;
}
__device__ __forceinline__ float silu_f(float x) { return x / (1.0f + __expf(-x)); }
__device__ __forceinline__ float ex2(float x) { return __builtin_amdgcn_exp2f(x); }

#define XB_TMO      128
#define XB_XCNT(j)  (256  + 64 * (j))
#define XB_XSUB(j)  (1280 + 64 * (j))
#define XB_XGEN(j)  (2304 + 64 * (j))
#define XB_TOP      3328
#define XB_TOPGEN   3392
#define XCD_BAR_WORDS 3456
#define XB_SPIN_CAP (1u << 18)
__device__ __forceinline__ unsigned xb_ld(unsigned* p)              { return __hip_atomic_load(p, __ATOMIC_RELAXED, __HIP_MEMORY_SCOPE_AGENT); }
__device__ __forceinline__ unsigned xb_add(unsigned* p, unsigned v) { return __hip_atomic_fetch_add(p, v, __ATOMIC_RELAXED, __HIP_MEMORY_SCOPE_AGENT); }
__device__ __forceinline__ unsigned xb_xcc_id() { return (unsigned)__builtin_amdgcn_s_getreg((3 << 11) | 20) & 0xFu; }
#define XB_SPIN(cond, bar) do { unsigned _sp = 0; while (cond) { __builtin_amdgcn_s_sleep(1); \
    if ((++_sp & 255u) == 0u) { if (xb_ld(&(bar)[XB_TMO])) break; if (_sp > XB_SPIN_CAP) { atomicAdd(&(bar)[XB_TMO], 1u); break; } } } } while (0)
struct XcdBarrier { unsigned* bar; unsigned x; volatile LAS unsigned* st; };
__device__ __forceinline__ XcdBarrier xcd_barrier_post(unsigned* bar, volatile LAS unsigned* st) {
    XcdBarrier b; b.bar = bar; b.x = xb_xcc_id(); b.st = st;
    if (threadIdx.x == 0) (void)xb_add(&bar[XB_XCNT(b.x)], 1u);
    return b;
}
__device__ __forceinline__ void xcd_barrier_complete(unsigned* bar, unsigned x, unsigned& nloc, unsigned& nx) {
    const unsigned G = gridDim.x * gridDim.y * gridDim.z;
    unsigned sum, cnt, mine, sp = 0u;
    for (;;) {
        sum = 0u; cnt = 0u; mine = 0u;
#pragma unroll
        for (unsigned j = 0; j < 16; ++j) { const unsigned c = xb_ld(&bar[XB_XCNT(j)]); sum += c; cnt += (c > 0u) ? 1u : 0u; mine = (j == x) ? c : mine; }
        if (sum == G) break;
        __builtin_amdgcn_s_sleep(1);
        if ((++sp & 255u) == 0u) { if (xb_ld(&bar[XB_TMO])) break; if (sp > XB_SPIN_CAP) { atomicAdd(&bar[XB_TMO], 1u); break; } }
    }
    nloc = mine > 0u ? mine : 1u; nx = cnt > 0u ? cnt : 1u;
}
__device__ __forceinline__ void xcd_barrier(const XcdBarrier& b) {
    asm volatile("s_waitcnt vmcnt(0)" ::: "memory");
    __syncthreads();
    if (threadIdx.x == 0) {
        unsigned* bar = b.bar;
        __builtin_amdgcn_s_waitcnt(0);
        unsigned nloc = b.st[0], nx = b.st[1];
        if (nloc == 0u) { xcd_barrier_complete(bar, b.x, nloc, nx); b.st[0] = nloc; b.st[1] = nx; }
        const unsigned old = xb_add(&bar[XB_XSUB(b.x)], 1u);
        const unsigned gen = old / nloc;
        if (old + 1u == (gen + 1u) * nloc) {
            __builtin_amdgcn_fence(__ATOMIC_RELEASE, "agent");
            asm volatile("s_waitcnt vmcnt(0)" ::: "memory");
            const unsigned og = xb_add(&bar[XB_TOP], 1u);
            const unsigned tg = og / nx;
            if (og + 1u == (tg + 1u) * nx) xb_add(&bar[XB_TOPGEN], 1u);
            else XB_SPIN(xb_ld(&bar[XB_TOPGEN]) == tg, bar);
            __builtin_amdgcn_fence(__ATOMIC_ACQUIRE, "agent");
            xb_add(&bar[XB_XGEN(b.x)], 1u);
            asm volatile("s_waitcnt vmcnt(0)" ::: "memory");
        } else {
            XB_SPIN(xb_ld(&bar[XB_XGEN(b.x)]) == gen, bar);
            __builtin_amdgcn_fence(__ATOMIC_ACQUIRE, "agent");
            asm volatile("s_waitcnt vmcnt(0)" ::: "memory");
        }
    }
    __syncthreads();
}

struct Args { const float* in[16]; float* out; unsigned char* ws; int ph_lo, ph_hi; };
struct Frame {
    LAS unsigned char* lds;
    volatile LAS unsigned* MISC;
    int tid, lane, wave, G, bid;
    const float *x_p, *x_s, *c_p, *c_s, *ck, *cv, *state, *w_mod, *b_mod, *g_pre, *g_post, *w_in, *w_a2, *b_a2, *g_gla, *w_out;
    float* out;
    bf16 *WinT, *WoT, *H, *QA, *KA, *VA, *GA, *QG, *KG, *VG, *GG, *MIX, *SPREV;
    float *MOD, *CS, *LA, *QS, *SLOC, *ACH, *Y;
};

__device__ __forceinline__ bf16x8 frag_tr2(LAS const unsigned char* tile, int pitch, int ra, int rb, int col0, int fr, int fq) {
    typedef short v4i16_t __attribute__((ext_vector_type(4)));
    const int q = fr >> 2, p = fr & 3;
    const s16x4 lo = __builtin_bit_cast(s16x4, __builtin_amdgcn_ds_read_tr16_b64_v4i16((LAS v4i16_t*)(tile + (ra + 4 * fq + q) * pitch + (col0 + 4 * p) * 2)));
    const s16x4 hi = __builtin_bit_cast(s16x4, __builtin_amdgcn_ds_read_tr16_b64_v4i16((LAS v4i16_t*)(tile + (rb + 4 * fq + q) * pitch + (col0 + 4 * p) * 2)));
    return (bf16x8){lo[0], lo[1], lo[2], lo[3], hi[0], hi[1], hi[2], hi[3]};
}

__device__ __forceinline__ void p0_transpose_item(const float* W, int K, int ldw, int nblk, bf16* WT, LAS float* scr, int item, int lane, int rot_limit) {
    const int kb = item / nblk, nb = item % nblk, k0 = 64 * kb, n0 = 32 * nb;
    int l = lane & 31;
    if (n0 < rot_limit && !(n0 & 32) && l < 16) l = (l & 3) | ((l & 4) << 1) | ((l & 8) >> 1);
#pragma unroll 8
    for (int i = 0; i < 32; ++i) { const int kk = 2 * i + (lane >> 5); scr[kk * 33 + (lane & 31)] = W[(size_t)(k0 + kk) * ldw + n0 + l]; }
    LDS_WAIT(); asm volatile("" ::: "memory");
    const int c = lane & 7;
#pragma unroll
    for (int j = 0; j < 4; ++j) { const int n = (lane >> 3) + 8 * j; const LAS float* s = scr + (8 * c) * 33 + n;
        v4u o; o.x = pk2(s[0 * 33], s[1 * 33]); o.y = pk2(s[2 * 33], s[3 * 33]); o.z = pk2(s[4 * 33], s[5 * 33]); o.w = pk2(s[6 * 33], s[7 * 33]);
        *(GAS v4u*)(WT + (size_t)(n0 + n) * K + k0 + 8 * c) = o; }
    LDS_WAIT(); asm volatile("" ::: "memory");
}

__device__ __forceinline__ void p0_prologue(Frame& F) {
    const int fr = F.lane & 15, fq = F.lane >> 4;
    if (F.bid < 192) {
        const int n0 = 16 * F.bid;
        f32x4 acc[9];
#pragma unroll
        for (int rt = 0; rt < 9; ++rt) acc[rt] = (f32x4){0.f, 0.f, 0.f, 0.f};
        for (int ks = 0; ks < 4; ++ks) {
            const int k0 = 128 * F.wave + 32 * ks + 8 * fq;
            float wv[8];
#pragma unroll
            for (int j = 0; j < 8; ++j) wv[j] = F.w_mod[(size_t)(k0 + j) * 3072 + n0 + fr];
            v4u bw; bw.x = pk2(wv[0], wv[1]); bw.y = pk2(wv[2], wv[3]); bw.z = pk2(wv[4], wv[5]); bw.w = pk2(wv[6], wv[7]);
            const bf16x8 bfrag = __builtin_bit_cast(bf16x8, bw);
#pragma unroll
            for (int rt = 0; rt < 9; ++rt) {
                const int row = 16 * rt + fr;
                v4u aw = (v4u){0u, 0u, 0u, 0u};
                if (row < NMODROWS) {
                    const float* cr = (row < BP) ? (F.c_p + (size_t)row * D) : (F.c_s + (size_t)(row - BP) * D);
                    const f32x4 a0 = *(const f32x4*)(cr + k0), a1 = *(const f32x4*)(cr + k0 + 4);
                    aw.x = pk2(silu_f(a0[0]), silu_f(a0[1])); aw.y = pk2(silu_f(a0[2]), silu_f(a0[3]));
                    aw.z = pk2(silu_f(a1[0]), silu_f(a1[1])); aw.w = pk2(silu_f(a1[2]), silu_f(a1[3]));
                }
                acc[rt] = __builtin_amdgcn_mfma_f32_16x16x32_bf16(__builtin_bit_cast(bf16x8, aw), bfrag, acc[rt], 0, 0, 0);
            }
        }
        LAS f32x4* red = (LAS f32x4*)F.lds;
#pragma unroll
        for (int rt = 0; rt < 9; ++rt) red[(F.wave * 9 + rt) * 64 + F.lane] = acc[rt];
        __syncthreads();
        for (int idx = F.tid; idx < 576; idx += NTHR) {
            f32x4 s = red[idx];
#pragma unroll
            for (int w = 1; w < 8; ++w) s += red[w * 576 + idx];
            const int rt = idx >> 6, l2 = idx & 63, c = n0 + (l2 & 15);
            const float bb = F.b_mod[c];
#pragma unroll
            for (int j = 0; j < 4; ++j) { const int row = 16 * rt + 4 * (l2 >> 4) + j; if (row < NMODROWS) F.MOD[(size_t)row * 3072 + c] = s[j] + bb; }
        }
        __syncthreads();
    }
    {
        LAS float* scr = (LAS float*)(F.lds + F.wave * 16384);
        const int gw = F.bid * NWAVES + F.wave, NGW = F.G * NWAVES;
        constexpr int I_IN = (D / 64) * (NZ / 32), I_OUT = (D / 64) * (D / 32);
        for (int it = gw; it < I_IN + I_OUT; it += NGW) {
            if (it < I_IN) p0_transpose_item(F.w_in, D, DIN, NZ / 32, F.WinT, scr, it, F.lane, 1024);
            else p0_transpose_item(F.w_out, D, D, D / 32, F.WoT, scr, it - I_IN, F.lane, 0);
        }
    }
    {
        const int gt = F.bid * NTHR + F.tid;
        if (gt < 4104 * 8) {
            const int p = gt >> 3, j = gt & 7;
            const double inv2pi[8] = {0.1591549430918953357688837633725143622471, 0.03086376340470122932315546430884944051186, 0.005985185712713705463431157792641031384955,
                                      0.001160663641240060843798466127071045088302, 0.0002250790790392765173887997977516851459669, 0.00004364795279280289038055931794818842687650,
                                      0.000008464330808241401245229928452035203497739, 0.000001641426262795034400875760625523723614375};
            double iv = inv2pi[0];
#pragma unroll
            for (int q = 1; q < 8; ++q) iv = (j == q) ? inv2pi[q] : iv;
            const int pos = p < SP ? p : 8192 + (p - SP);
            const double rev = (double)pos * iv;
            const float fr2 = (float)(rev - __builtin_rint(rev));
            F.CS[2 * gt] = __builtin_amdgcn_cosf(fr2); F.CS[2 * gt + 1] = __builtin_amdgcn_sinf(fr2);
        }
    }
}

__device__ __forceinline__ void p1_norm(Frame& F) {
    constexpr int WTP = 1028;
    LAS float* WTA = (LAS float*)F.lds;
    LAS float* WA2 = (LAS float*)(F.lds + 16 * WTP * 4);
    LAS float* BA2 = WA2 + 16 * 256;
    for (int i = F.tid; i < 16 * 1024; i += NTHR) { const int k = i >> 4, r = i & 15; WTA[r * WTP + k] = F.w_in[(size_t)k * DIN + NZ + r]; }
    for (int i = F.tid; i < 16 * 256; i += NTHR) WA2[i] = F.w_a2[i];
    if (F.tid < 256) BA2[F.tid] = F.b_a2[F.tid];
    __syncthreads();
    const int gw = F.bid * NWAVES + F.wave, NGW = F.G * NWAVES;
    for (int m = gw; m < MROWS; m += NGW) {
        const float* xr = (m < MP) ? (F.x_p + (size_t)m * D) : (F.x_s + (size_t)(m - MP) * D);
        const int mr = (m < MP) ? (m >> 12) : (BP + ((m - MP) >> 3));
        const float* mod = F.MOD + (size_t)mr * 3072;
        f32x4 v[4]; float ss = 0.f;
#pragma unroll
        for (int j = 0; j < 4; ++j) { v[j] = *(const f32x4*)(xr + 4 * F.lane + 256 * j); ss += (v[j][0] * v[j][0] + v[j][1] * v[j][1]) + (v[j][2] * v[j][2] + v[j][3] * v[j][3]); }
        const float rstd = 1.0f / sqrtf(wave_sum(ss) * (1.0f / D) + EPSN);
#pragma unroll
        for (int j = 0; j < 4; ++j) {
            const int c = 4 * F.lane + 256 * j;
            const f32x4 g = *(const f32x4*)(F.g_pre + c), sh = *(const f32x4*)(mod + c), sc = *(const f32x4*)(mod + 1024 + c);
            v[j] = (v[j] * rstd) * g * (sc + 1.0f) + sh;
            v2u o; o.x = pk2(v[j][0], v[j][1]); o.y = pk2(v[j][2], v[j][3]);
            *(v2u*)(F.H + (size_t)m * D + c) = o;
        }
        float alr[16];
#pragma unroll
        for (int r = 0; r < 16; ++r) {
            float p = 0.f;
#pragma unroll
            for (int j = 0; j < 4; ++j) { const f32x4 w = *(const LAS f32x4*)(WTA + r * WTP + 4 * F.lane + 256 * j); p += (v[j][0] * w[0] + v[j][1] * w[1]) + (v[j][2] * w[2] + v[j][3] * w[3]); }
            alr[r] = wave_sum(p);
            asm volatile("" ::: "memory");
        }
#pragma unroll
        for (int jj = 0; jj < 4; ++jj) {
            const int c = F.lane + 64 * jj;
            float xg = BA2[c];
#pragma unroll
            for (int r = 0; r < 16; ++r) xg += alr[r] * WA2[r * 256 + c];
            const float ls = fminf(xg, 0.f) - __logf(1.0f + __expf(-fabsf(xg)));
            F.LA[(size_t)m * 256 + c] = ls * (1.0f / 16.0f);
        }
    }
}

struct EpiProj {
    static constexpr bool PERM = true, AFTER_DRAIN = false;
    unsigned char* ws; float* out;
    __device__ __forceinline__ void operator()(const pg8::f32x4 (&acc)[2][2][4][2], const pg8::Unit& u, int wr, int wc, int fr, int fq) const {
        const int pn = u.pn, pm = u.pm;
        const bool sample = pm >= 64;
        bf16* const QA = (bf16*)(ws + WS_QA); bf16* const KA = (bf16*)(ws + WS_KA); bf16* const VA = (bf16*)(ws + WS_VA); bf16* const GA = (bf16*)(ws + WS_GA);
        bf16* const QG = (bf16*)(ws + WS_QG); bf16* const KG = (bf16*)(ws + WS_KG); bf16* const VG = (bf16*)(ws + WS_VG); bf16* const GG = (bf16*)(ws + WS_GG);
        float* const QS = (float*)(ws + WS_QS); const float* const CS = (const float*)(ws + WS_CS);
#pragma unroll
        for (int ai = 0; ai < 2; ++ai)
#pragma unroll
            for (int m = 0; m < 4; ++m) {
                const int rl = 128 * ai + 64 * wr + 16 * m + fr;
                const size_t grow = (size_t)pm * 256 + rl;
                const int pos = ((pm & 15) << 8) + rl;
                const int csidx = sample ? (SP + (rl & 7)) : pos;
                const int bb = sample ? (((pm - 64) * 256 + rl) >> 3) : (pm >> 4);
#pragma unroll
                for (int bj = 0; bj < 2; ++bj) {
                    f32x4 v0 = acc[ai][bj][m][0], v1 = acc[ai][bj][m][1];
                    const int ct = 128 * bj + 32 * wc + 8 * fq;
                    if (pn < 6) {
                        const int head = (pn & 1) * 4 + (ct >> 6), hp = ct & 63;
                        int oc0 = hp, oc1 = hp + 4;
                        if (pn < 4 && hp < 16) {
                            const int d0 = hp >> 1;
                            oc0 = d0; oc1 = d0 + 8;
                            const f32x4 t0 = *(const f32x4*)(CS + ((size_t)csidx * 8 + d0) * 2), t1 = *(const f32x4*)(CS + ((size_t)csidx * 8 + d0) * 2 + 4);
                            const float cc[4] = {t0[0], t0[2], t1[0], t1[2]}, sn[4] = {t0[1], t0[3], t1[1], t1[3]};
#pragma unroll
                            for (int j = 0; j < 4; ++j) { const float x1 = v0[j], x2 = v1[j]; v0[j] = x1 * cc[j] - x2 * sn[j]; v1[j] = x2 * cc[j] + x1 * sn[j]; }
                        }
                        if (pn < 2) { v0 = v0 * QSCALE; v1 = v1 * QSCALE; }
                        if (!sample) {
                            bf16* dst = (pn < 2 ? QA : (pn < 4 ? KA : VA)) + grow * DATT + head * 64 + hp;
                            v4u w; w.x = pk2(v0[0], v0[1]); w.y = pk2(v0[2], v0[3]); w.z = pk2(v1[0], v1[1]); w.w = pk2(v1[2], v1[3]);
                            *(v4u*)dst = w;
                            if (pn >= 2 && pos >= SP - WB) {
                                float* o = out + (pn < 4 ? O_KWP : O_VWP) + (((size_t)bb * WB + (pos - (SP - WB))) * 8 + head) * 64;
                                *(f32x4*)(o + oc0) = v0; *(f32x4*)(o + oc1) = v1;
                            }
                        } else {
                            const int i = rl & 7;
                            float* o;
                            if (pn < 2) o = QS + ((size_t)(grow - MP)) * DATT + head * 64;
                            else o = out + (pn < 4 ? O_KWS : O_VWS) + (((size_t)bb * WB + (WB - TS + i)) * 8 + head) * 64;
                            *(f32x4*)(o + oc0) = v0; *(f32x4*)(o + oc1) = v1;
                        }
                    } else {
                        bf16* dst;
                        if (pn < 8)       { dst = GA + grow * 512 + (pn - 6) * 256 + ct;
#pragma unroll
                            for (int j = 0; j < 4; ++j) { v0[j] = silu_f(v0[j]); v1[j] = silu_f(v1[j]); } }
                        else if (pn == 8) { dst = QG + grow * 256 + ct; v0 = v0 * 0.125f; v1 = v1 * 0.125f; }
                        else if (pn == 9) { dst = KG + grow * 256 + ct; }
                        else if (pn < 12) { dst = VG + grow * 512 + (pn - 10) * 256 + ct; }
                        else              { dst = GG + grow * 512 + (pn - 12) * 256 + ct;
#pragma unroll
                            for (int j = 0; j < 4; ++j) { v0[j] = silu_f(v0[j]); v1[j] = silu_f(v1[j]); } }
                        v4u w; w.x = pk2(v0[0], v0[1]); w.y = pk2(v0[2], v0[3]); w.z = pk2(v1[0], v1[1]); w.w = pk2(v1[2], v1[3]);
                        *(v4u*)dst = w;
                    }
                }
                asm volatile("" ::: "memory");
            }
    }
};
struct EpiF32 {
    static constexpr bool PERM = false, AFTER_DRAIN = false;
    float* C; int ldc;
    __device__ __forceinline__ void operator()(const pg8::f32x4 (&acc)[2][2][4][2], const pg8::Unit& u, int wr, int wc, int fr, int fq) const {
        const int row0 = u.pm * 256 + wr * 64 + fr, col0 = u.pn * 256 + wc * 32 + 4 * fq;
#pragma unroll
        for (int ai = 0; ai < 2; ++ai)
#pragma unroll
            for (int m = 0; m < 4; ++m) { float* rowp = C + (size_t)(row0 + ai * 128 + m * 16) * ldc + col0;
#pragma unroll
                for (int bj = 0; bj < 2; ++bj)
#pragma unroll
                    for (int n = 0; n < 2; ++n) *(f32x4*)(rowp + bj * 128 + n * 16) = acc[ai][bj][m][n]; }
    }
};

constexpr int VP_ATT = 144;
__device__ __forceinline__ void attn_wave_tile(Frame& F, int b, int h, int P, LAS unsigned char* vbuf) {
    const int lane = F.lane, fr = lane & 15, fq = lane >> 4;
    const size_t rowb = (size_t)b * SP;
    const int pq = P + 16 * fr;
    bf16x8 qf[2];
#pragma unroll
    for (int ks = 0; ks < 2; ++ks) qf[ks] = *(const bf16x8*)(F.QA + (rowb + pq) * DATT + h * 64 + 32 * ks + 8 * fq);
    f32x4 o[4];
#pragma unroll
    for (int n = 0; n < 4; ++n) o[n] = (f32x4){0.f, 0.f, 0.f, 0.f};
    float lsum = 0.f, mref = -1e30f;
#pragma unroll 1
    for (int pat = 0; pat < 3; ++pat) {
        const int d = (pat == 0) ? 16 : (pat == 1 ? 4 : 1), sh = (pat == 0) ? 4 : (pat == 1 ? 2 : 0), s = 16 >> sh;
        const int npairs = (pat == 0) ? 5 : (pat == 1 ? 6 : 12);
        const int res = P & (d - 1), N0 = P >> sh;
        const int nq = N0 + s * fr;
        const unsigned lim = (unsigned)(nq < 128 ? nq : 128);
#pragma unroll 1
        for (int pr = 0; pr < npairs; ++pr) {
            const int kb = N0 - 128 + 32 * pr;
            if (kb + 31 < 0) continue;
            bf16x8 ka[2], kbf[2];
            {
                int n1 = kb + fr; n1 = n1 < 0 ? 0 : n1; int p1 = n1 * d + res; p1 = p1 > SP - 1 ? SP - 1 : p1;
                int n2 = kb + 16 + fr; n2 = n2 < 0 ? 0 : n2; int p2 = n2 * d + res; p2 = p2 > SP - 1 ? SP - 1 : p2;
                const bf16* k1 = F.KA + (rowb + p1) * DATT + h * 64 + 8 * fq; const bf16* k2 = F.KA + (rowb + p2) * DATT + h * 64 + 8 * fq;
                ka[0] = *(const bf16x8*)k1; ka[1] = *(const bf16x8*)(k1 + 32); kbf[0] = *(const bf16x8*)k2; kbf[1] = *(const bf16x8*)(k2 + 32);
            }
            v4u vv[4];
#pragma unroll
            for (int i = 0; i < 4; ++i) { int n1 = kb + 8 * i + (lane >> 3); n1 = n1 < 0 ? 0 : n1; int p1 = n1 * d + res; p1 = p1 > SP - 1 ? SP - 1 : p1;
                vv[i] = *(const v4u*)(F.VA + (rowb + p1) * DATT + h * 64 + 8 * (lane & 7)); }
            f32x4 sa = (f32x4){0.f, 0.f, 0.f, 0.f}, sb = (f32x4){0.f, 0.f, 0.f, 0.f};
            sa = __builtin_amdgcn_mfma_f32_16x16x32_bf16(ka[0], qf[0], sa, 0, 0, 0); sa = __builtin_amdgcn_mfma_f32_16x16x32_bf16(ka[1], qf[1], sa, 0, 0, 0);
            sb = __builtin_amdgcn_mfma_f32_16x16x32_bf16(kbf[0], qf[0], sb, 0, 0, 0); sb = __builtin_amdgcn_mfma_f32_16x16x32_bf16(kbf[1], qf[1], sb, 0, 0, 0);
#pragma unroll
            for (int i = 0; i < 4; ++i) *(LAS v4u*)(vbuf + (8 * i + (lane >> 3)) * VP_ATT + 16 * (lane & 7)) = vv[i];
            const int dist0 = 128 + s * fr - 32 * pr - 4 * fq;
            float lmax = -INFINITY;
#pragma unroll
            for (int j = 0; j < 4; ++j) {
                sa[j] = ((unsigned)(dist0 - j) <= lim) ? sa[j] : -INFINITY;
                sb[j] = ((unsigned)(dist0 - 16 - j) <= lim) ? sb[j] : -INFINITY;
                lmax = fmaxf(lmax, fmaxf(sa[j], sb[j]));
            }
            if (__any(lmax > mref + 8.0f)) {
                float rm = fmaxf(lmax, __shfl_xor(lmax, 16)); rm = fmaxf(rm, __shfl_xor(rm, 32));
                const float mnew = fmaxf(mref, rm), al = ex2(mref - mnew);
#pragma unroll
                for (int n = 0; n < 4; ++n) o[n] = o[n] * al;
                lsum *= al; mref = mnew;
            }
            float pa[4], pb[4];
#pragma unroll
            for (int j = 0; j < 4; ++j) { pa[j] = ex2(sa[j] - mref); pb[j] = ex2(sb[j] - mref); lsum += pa[j] + pb[j]; }
            v4u pw; pw.x = pk2(pa[0], pa[1]); pw.y = pk2(pa[2], pa[3]); pw.z = pk2(pb[0], pb[1]); pw.w = pk2(pb[2], pb[3]);
            const bf16x8 pf = __builtin_bit_cast(bf16x8, pw);
#pragma unroll
            for (int n = 0; n < 4; ++n) { const bf16x8 vf = frag_tr2(vbuf, VP_ATT, 0, 16, 16 * n, fr, fq); o[n] = __builtin_amdgcn_mfma_f32_16x16x32_bf16(vf, pf, o[n], 0, 0, 0); }
        }
    }
    lsum += __shfl_xor(lsum, 16); lsum += __shfl_xor(lsum, 32);
    const float inv = 1.0f / lsum;
    const size_t row = rowb + pq;
#pragma unroll
    for (int n = 0; n < 4; ++n) {
        const int c = h * 64 + 16 * n + 4 * fq;
        const v2u g = *(const v2u*)(F.GA + row * 512 + c);
        v2u w; w.x = pk2(o[n][0] * inv * bflo(g.x), o[n][1] * inv * bfhi(g.x)); w.y = pk2(o[n][2] * inv * bflo(g.y), o[n][3] * inv * bfhi(g.y));
        *(v2u*)(F.MIX + row * 1024 + c) = w;
    }
}
__device__ __forceinline__ void p3_attn_prompt(Frame& F) {
    LAS unsigned char* vbuf = F.lds + F.wave * 8192;
    for (int u = F.bid; u < BP * 8 * 16; u += F.G) {
        const int b = u >> 7, h = (u >> 4) & 7, p0 = (u & 15) << 8;
        attn_wave_tile(F, b, h, p0 + F.wave, vbuf);
        attn_wave_tile(F, b, h, p0 + F.wave + 8, vbuf);
    }
}

__device__ __forceinline__ void p3_attn_sample(Frame& F) {
    const int lane = F.lane, l16 = lane & 15, g4 = lane >> 4;
    for (int u = F.bid; u < BS * 2; u += F.G) {
        const int b = u >> 1, head = 4 * (u & 1) + (F.wave & 3);
        const float* kws = F.out + O_KWS; const float* vws = F.out + O_VWS;
        for (int ii = 0; ii < 4; ++ii) {
            const int i = 4 * (F.wave >> 2) + ii;
            const size_t srow = (size_t)b * TS + i;
            const f32x4 q4 = *(const f32x4*)(F.QS + srow * DATT + head * 64 + 4 * l16);
            float m = -1e30f, l = 0.f; f32x4 o = (f32x4){0.f, 0.f, 0.f, 0.f};
#pragma unroll 1
            for (int pat = 0; pat < 3; ++pat) {
                const int d = (pat == 0) ? 1 : (pat == 1 ? 4 : 16);
#pragma unroll 2
                for (int st = 0; st < 33; ++st) {
                    const int j = 4 * st + g4; const bool valid = j <= 128; const int jc = valid ? j : 128;
                    const int idx = WB + i - jc * d;
                    const size_t off = (idx < WB) ? ((((size_t)b * WB + idx) * 8 + head) * 64) : ((((size_t)b * WB + (idx - TS)) * 8 + head) * 64);
                    const float* kp = (idx < WB ? F.ck : kws) + off + 4 * l16; const float* vp = (idx < WB ? F.cv : vws) + off + 4 * l16;
                    const f32x4 k4 = *(const f32x4*)kp, v4 = *(const f32x4*)vp;
                    float s = (q4[0] * k4[0] + q4[1] * k4[1]) + (q4[2] * k4[2] + q4[3] * k4[3]);
                    s += __shfl_xor(s, 1); s += __shfl_xor(s, 2); s += __shfl_xor(s, 4); s += __shfl_xor(s, 8);
                    s = valid ? s : -INFINITY;
                    const float mn = fmaxf(m, s), al = ex2(m - mn), p = ex2(s - mn);
                    l = l * al + p; o = o * al + v4 * p; m = mn;
                }
            }
#pragma unroll
            for (int off = 16; off < 64; off <<= 1) {
                const float m2 = __shfl_xor(m, off), l2 = __shfl_xor(l, off);
                f32x4 o2; o2[0] = __shfl_xor(o[0], off); o2[1] = __shfl_xor(o[1], off); o2[2] = __shfl_xor(o[2], off); o2[3] = __shfl_xor(o[3], off);
                const float mn = fmaxf(m, m2), a1 = ex2(m - mn), a2 = ex2(m2 - mn);
                l = l * a1 + l2 * a2; o = o * a1 + o2 * a2; m = mn;
            }
            if (g4 == 0) {
                const size_t row = (size_t)MP + srow; const int c = head * 64 + 4 * l16; const float inv = 1.0f / l;
                const v2u g = *(const v2u*)(F.GA + row * 512 + c);
                v2u w; w.x = pk2(o[0] * inv * bflo(g.x), o[1] * inv * bfhi(g.x)); w.y = pk2(o[2] * inv * bflo(g.y), o[3] * inv * bfhi(g.y));
                *(v2u*)(F.MIX + row * 1024 + c) = w;
            }
        }
    }
}

__device__ __forceinline__ void p3_copy(Frame& F) {
    constexpr int N4 = (WB - TS) * DATT / 4;
    for (int u = F.bid; u < 2 * BS; u += F.G) {
        const int t = u >> 7, b = u & 127;
        const f32x4* src = (const f32x4*)((t ? F.cv : F.ck) + ((size_t)b * WB + TS) * DATT);
        f32x4* dst = (f32x4*)(F.out + (t ? O_VWS : O_KWS) + (size_t)b * WB * DATT);
        for (int base = 0; base < N4; base += 4 * NTHR) {
            f32x4 v[4];
#pragma unroll
            for (int k = 0; k < 4; ++k) { const int o = base + k * NTHR + F.tid; if (o < N4) v[k] = __builtin_nontemporal_load(src + o); }
#pragma unroll
            for (int k = 0; k < 4; ++k) { const int o = base + k * NTHR + F.tid; if (o < N4) __builtin_nontemporal_store(v[k], dst + o); }
        }
    }
}

constexpr int GP64 = 144, GP128 = 272, LBP = 65;
constexpr int GL_B = 0, GL_Q = 16640, GL_K = GL_Q + 64 * GP64, GL_V = GL_K + 64 * GP64, GL_QI = GL_V + 64 * GP128, GL_RED = GL_QI + 64 * GP64;
template <bool WITHQ> __device__ __forceinline__ void gla_stage(Frame& F, int b, int h, int n) {
    LAS float* Lb = (LAS float*)(F.lds + GL_B);
    const size_t r0 = (size_t)b * SP + 64 * n;
#pragma unroll
    for (int k = 0; k < 8; ++k) { const int i = F.tid + NTHR * k, t = i >> 6, c = i & 63; Lb[t * LBP + c] = F.LA[(r0 + t) * 256 + h * 64 + c]; }
    { const int t = F.tid >> 3, ch = F.tid & 7;
      *(LAS v4u*)(F.lds + GL_K + t * GP64 + 16 * ch) = *(const v4u*)(F.KG + (r0 + t) * 256 + h * 64 + 8 * ch);
      if (WITHQ) *(LAS v4u*)(F.lds + GL_Q + t * GP64 + 16 * ch) = *(const v4u*)(F.QG + (r0 + t) * 256 + h * 64 + 8 * ch); }
#pragma unroll
    for (int k = 0; k < 2; ++k) { const int i = F.tid + NTHR * k, t = i >> 4, ch = i & 15;
      *(LAS v4u*)(F.lds + GL_V + t * GP128 + 16 * ch) = *(const v4u*)(F.VG + (r0 + t) * 512 + h * 128 + 8 * ch); }
    __syncthreads();
    if (F.tid < 64) { float run = 0.f;
#pragma unroll 8
        for (int t = 0; t < 64; ++t) { run += Lb[t * LBP + F.tid]; Lb[t * LBP + F.tid] = run; } }
    __syncthreads();
}
__device__ __forceinline__ void p3_gla_local(Frame& F) {
    const int fr = F.lane & 15, fq = F.lane >> 4;
    LAS float* Lb = (LAS float*)(F.lds + GL_B);
    for (int u = F.bid; u < NGLA_UNITS; u += F.G) {
        const int bh = u >> 6, b = bh >> 2, h = bh & 3, n = u & 63;
        gla_stage<false>(F, b, h, n);
        { const int t = F.tid >> 3, ch = F.tid & 7;
          LAS v4u* kp = (LAS v4u*)(F.lds + GL_K + t * GP64 + 16 * ch); const v4u kw = *kp; float kt[8];
          const unsigned kwv[4] = {kw.x, kw.y, kw.z, kw.w};
#pragma unroll
          for (int e = 0; e < 8; ++e) { const int c = 8 * ch + e; const float kv = (e & 1) ? bfhi(kwv[e >> 1]) : bflo(kwv[e >> 1]); kt[e] = kv * __expf(Lb[63 * LBP + c] - Lb[t * LBP + c]); }
          v4u o; o.x = pk2(kt[0], kt[1]); o.y = pk2(kt[2], kt[3]); o.z = pk2(kt[4], kt[5]); o.w = pk2(kt[6], kt[7]);
          *kp = o; }
        if (F.tid < 64) F.ACH[(size_t)u * 64 + F.tid] = __expf(Lb[63 * LBP + F.tid]);
        __syncthreads();
        const int v0 = 16 * F.wave;
        f32x4 acc[4];
#pragma unroll
        for (int ct = 0; ct < 4; ++ct) acc[ct] = (f32x4){0.f, 0.f, 0.f, 0.f};
#pragma unroll
        for (int ks = 0; ks < 2; ++ks) {
            const bf16x8 vf = frag_tr2(F.lds + GL_V, GP128, 32 * ks, 32 * ks + 16, v0, fr, fq);
#pragma unroll
            for (int ct = 0; ct < 4; ++ct) { const bf16x8 kf = frag_tr2(F.lds + GL_K, GP64, 32 * ks, 32 * ks + 16, 16 * ct, fr, fq);
                acc[ct] = __builtin_amdgcn_mfma_f32_16x16x32_bf16(kf, vf, acc[ct], 0, 0, 0); }
        }
#pragma unroll
        for (int ct = 0; ct < 4; ++ct) *(f32x4*)(F.SLOC + (size_t)u * 8192 + (size_t)(v0 + fr) * 64 + 16 * ct + 4 * fq) = acc[ct];
        __syncthreads();
    }
}
__device__ __forceinline__ void p4_gla_scan(Frame& F) {
    for (int w = F.bid; w < 256; w += F.G) {
        const int bh = w >> 4, e = (w & 15) * NTHR + F.tid, v = e >> 6, c = e & 63;
        float S = 0.f;
#pragma unroll 8
        for (int n = 0; n < 64; ++n) { const size_t u = (size_t)bh * 64 + n;
            const float a = F.ACH[u * 64 + c], sl = F.SLOC[u * 8192 + e];
            F.SPREV[u * 8192 + e] = (bf16)(pk2(S, 0.f) & 0xffffu);
            S = a * S + sl; }
        F.out[O_GP + ((size_t)bh * 64 + c) * 128 + v] = S;
    }
}
__device__ __forceinline__ void p5_gla_out(Frame& F) {
    const int fr = F.lane & 15, fq = F.lane >> 4;
    LAS float* Lb = (LAS float*)(F.lds + GL_B);
    LAS float* red = (LAS float*)(F.lds + GL_RED);
    for (int u = F.bid; u < NGLA_UNITS; u += F.G) {
        const int bh = u >> 6, b = bh >> 2, h = bh & 3, n = u & 63;
        gla_stage<true>(F, b, h, n);
        { const int t = F.tid >> 3, ch = F.tid & 7;
          LAS v4u* kp = (LAS v4u*)(F.lds + GL_K + t * GP64 + 16 * ch); LAS v4u* qp = (LAS v4u*)(F.lds + GL_Q + t * GP64 + 16 * ch); LAS v4u* qip = (LAS v4u*)(F.lds + GL_QI + t * GP64 + 16 * ch);
          const v4u kw = *kp, qw = *qp; const unsigned kwv[4] = {kw.x, kw.y, kw.z, kw.w}, qwv[4] = {qw.x, qw.y, qw.z, qw.w};
          float kt[8], qh[8], qi[8];
#pragma unroll
          for (int e = 0; e < 8; ++e) { const int c = 8 * ch + e; const float bt = Lb[t * LBP + c], bl = Lb[63 * LBP + c];
              const float kv = (e & 1) ? bfhi(kwv[e >> 1]) : bflo(kwv[e >> 1]), qv = (e & 1) ? bfhi(qwv[e >> 1]) : bflo(qwv[e >> 1]);
              kt[e] = kv * __expf(bl - bt); qh[e] = qv * __expf(bt - bl); qi[e] = qv * __expf(bt); }
          v4u o; o.x = pk2(kt[0], kt[1]); o.y = pk2(kt[2], kt[3]); o.z = pk2(kt[4], kt[5]); o.w = pk2(kt[6], kt[7]); *kp = o;
          o.x = pk2(qh[0], qh[1]); o.y = pk2(qh[2], qh[3]); o.z = pk2(qh[4], qh[5]); o.w = pk2(qh[6], qh[7]); *qp = o;
          o.x = pk2(qi[0], qi[1]); o.y = pk2(qi[2], qi[3]); o.z = pk2(qi[4], qi[5]); o.w = pk2(qi[6], qi[7]); *qip = o; }
        __syncthreads();
        const int tt = F.wave & 3, half = F.wave >> 2;
        f32x4 o[4];
#pragma unroll
        for (int vt = 0; vt < 4; ++vt) o[vt] = (f32x4){0.f, 0.f, 0.f, 0.f};
        bf16x8 qhf[2], qif[2];
#pragma unroll
        for (int ks = 0; ks < 2; ++ks) { qhf[ks] = *(const LAS bf16x8*)(F.lds + GL_Q + (16 * tt + fr) * GP64 + 64 * ks + 16 * fq); qif[ks] = *(const LAS bf16x8*)(F.lds + GL_QI + (16 * tt + fr) * GP64 + 64 * ks + 16 * fq); }
#pragma unroll
        for (int vt = 0; vt < 4; ++vt) { const int v = 64 * half + 16 * vt + fr;
#pragma unroll
            for (int ks = 0; ks < 2; ++ks) { const bf16x8 sf = *(const bf16x8*)(F.SPREV + (size_t)u * 8192 + (size_t)v * 64 + 32 * ks + 8 * fq);
                o[vt] = __builtin_amdgcn_mfma_f32_16x16x32_bf16(sf, qif[ks], o[vt], 0, 0, 0); } }
#pragma unroll
        for (int pr = 0; pr < 2; ++pr) {
            if (2 * pr <= tt) {
                f32x4 sa = (f32x4){0.f, 0.f, 0.f, 0.f}, sb = (f32x4){0.f, 0.f, 0.f, 0.f};
#pragma unroll
                for (int ks = 0; ks < 2; ++ks) {
                    const bf16x8 k1 = *(const LAS bf16x8*)(F.lds + GL_K + (32 * pr + fr) * GP64 + 64 * ks + 16 * fq), k2 = *(const LAS bf16x8*)(F.lds + GL_K + (32 * pr + 16 + fr) * GP64 + 64 * ks + 16 * fq);
                    sa = __builtin_amdgcn_mfma_f32_16x16x32_bf16(k1, qhf[ks], sa, 0, 0, 0); sb = __builtin_amdgcn_mfma_f32_16x16x32_bf16(k2, qhf[ks], sb, 0, 0, 0);
                }
                const int tg = 16 * tt + fr, s0 = 32 * pr + 4 * fq;
#pragma unroll
                for (int j = 0; j < 4; ++j) { sa[j] = (s0 + j <= tg) ? sa[j] : 0.f; sb[j] = (s0 + 16 + j <= tg) ? sb[j] : 0.f; }
                v4u pw; pw.x = pk2(sa[0], sa[1]); pw.y = pk2(sa[2], sa[3]); pw.z = pk2(sb[0], sb[1]); pw.w = pk2(sb[2], sb[3]);
                const bf16x8 pf = __builtin_bit_cast(bf16x8, pw);
#pragma unroll
                for (int vt = 0; vt < 4; ++vt) { const bf16x8 vf = frag_tr2(F.lds + GL_V, GP128, 32 * pr, 32 * pr + 16, 64 * half + 16 * vt, fr, fq);
                    o[vt] = __builtin_amdgcn_mfma_f32_16x16x32_bf16(vf, pf, o[vt], 0, 0, 0); }
            }
        }
        float ss = 0.f;
#pragma unroll
        for (int vt = 0; vt < 4; ++vt) ss += (o[vt][0] * o[vt][0] + o[vt][1] * o[vt][1]) + (o[vt][2] * o[vt][2] + o[vt][3] * o[vt][3]);
        ss += __shfl_xor(ss, 16); ss += __shfl_xor(ss, 32);
        if (fq == 0) red[half * 64 + 16 * tt + fr] = ss;
        __syncthreads();
        const float tot = red[16 * tt + fr] + red[64 + 16 * tt + fr];
        const float rstd = 1.0f / sqrtf(tot * (1.0f / 128.0f) + EPSN);
        const size_t row = (size_t)b * SP + 64 * n + 16 * tt + fr;
#pragma unroll
        for (int vt = 0; vt < 4; ++vt) {
            const int v = 64 * half + 16 * vt + 4 * fq;
            const f32x4 gg = *(const f32x4*)(F.g_gla + v);
            const v2u g = *(const v2u*)(F.GG + row * 512 + h * 128 + v);
            v2u w; w.x = pk2(o[vt][0] * rstd * gg[0] * bflo(g.x), o[vt][1] * rstd * gg[1] * bfhi(g.x)); w.y = pk2(o[vt][2] * rstd * gg[2] * bflo(g.y), o[vt][3] * rstd * gg[3] * bfhi(g.y));
            *(v2u*)(F.MIX + row * 1024 + 512 + h * 128 + v) = w;
        }
        __syncthreads();
    }
}

__device__ __forceinline__ void p3_gla_sample(Frame& F) {
    LAS float* red = (LAS float*)F.lds;
    const int c = F.tid >> 3, vg = F.tid & 7;
    for (int u = F.bid; u < BS * 4; u += F.G) {
        const int b = u >> 2, h = u & 3;
        const float* sp = F.state + ((size_t)u * 64 + c) * 128 + 16 * vg;
        f32x4 S[4];
#pragma unroll
        for (int q = 0; q < 4; ++q) S[q] = *(const f32x4*)(sp + 4 * q);
#pragma unroll 1
        for (int t = 0; t < TS; ++t) {
            const size_t row = (size_t)MP + (size_t)b * TS + t;
            const float a = __expf(F.LA[row * 256 + h * 64 + c]);
            const float kk = bf2f(F.KG[row * 256 + h * 64 + c]), qq = bf2f(F.QG[row * 256 + h * 64 + c]);
            const v4u va = *(const v4u*)(F.VG + row * 512 + h * 128 + 16 * vg), vb = *(const v4u*)(F.VG + row * 512 + h * 128 + 16 * vg + 8);
            const unsigned vw[8] = {va.x, va.y, va.z, va.w, vb.x, vb.y, vb.z, vb.w};
            float po[16];
#pragma unroll
            for (int e = 0; e < 16; ++e) { const float vv = (e & 1) ? bfhi(vw[e >> 1]) : bflo(vw[e >> 1]); S[e >> 2][e & 3] = a * S[e >> 2][e & 3] + kk * vv; po[e] = qq * S[e >> 2][e & 3]; }
#pragma unroll
            for (int e = 0; e < 16; ++e) { po[e] += __shfl_xor(po[e], 8); po[e] += __shfl_xor(po[e], 16); po[e] += __shfl_xor(po[e], 32); }
            if (F.lane < 8) {
#pragma unroll
                for (int e = 0; e < 16; ++e) red[(t * 8 + F.wave) * 128 + 16 * vg + e] = po[e]; }
        }
        float* so = F.out + O_GS + ((size_t)u * 64 + c) * 128 + 16 * vg;
#pragma unroll
        for (int q = 0; q < 4; ++q) *(f32x4*)(so + 4 * q) = S[q];
        __syncthreads();
        {
            const int t = F.wave; const size_t row = (size_t)MP + (size_t)b * TS + t;
            float ov[2]; float ss = 0.f;
#pragma unroll
            for (int k = 0; k < 2; ++k) { const int v = F.lane + 64 * k; float s = 0.f;
#pragma unroll
                for (int w = 0; w < 8; ++w) s += red[(t * 8 + w) * 128 + v];
                ov[k] = s; ss += s * s; }
            const float rstd = 1.0f / sqrtf(wave_sum(ss) * (1.0f / 128.0f) + EPSN);
#pragma unroll
            for (int k = 0; k < 2; ++k) { const int v = F.lane + 64 * k;
                const float val = ov[k] * rstd * F.g_gla[v] * bf2f(F.GG[row * 512 + h * 128 + v]);
                F.MIX[row * 1024 + 512 + h * 128 + v] = (bf16)(pk2(val, 0.f) & 0xffffu); }
        }
        __syncthreads();
    }
}

__device__ __forceinline__ void p7_final(Frame& F) {
    const int gw = F.bid * NWAVES + F.wave, NGW = F.G * NWAVES;
    for (int m = gw; m < MROWS; m += NGW) {
        const float* xr = (m < MP) ? (F.x_p + (size_t)m * D) : (F.x_s + (size_t)(m - MP) * D);
        float* orow = F.out + (size_t)m * D;
        const int mr = (m < MP) ? (m >> 12) : (BP + ((m - MP) >> 3));
        const float* gate = F.MOD + (size_t)mr * 3072 + 2048;
        const float* yr = F.Y + (size_t)m * D;
        f32x4 y[4]; float ss = 0.f;
#pragma unroll
        for (int j = 0; j < 4; ++j) { y[j] = *(const f32x4*)(yr + 4 * F.lane + 256 * j); ss += (y[j][0] * y[j][0] + y[j][1] * y[j][1]) + (y[j][2] * y[j][2] + y[j][3] * y[j][3]); }
        const float rstd = 1.0f / sqrtf(wave_sum(ss) * (1.0f / D) + EPSN);
#pragma unroll
        for (int j = 0; j < 4; ++j) { const int c = 4 * F.lane + 256 * j;
            const f32x4 xv = *(const f32x4*)(xr + c), g = *(const f32x4*)(F.g_post + c), gt = *(const f32x4*)(gate + c);
            *(f32x4*)(orow + c) = xv + gt * ((y[j] * rstd) * g); }
    }
}

__global__ void __launch_bounds__(NTHR, 2) mk_fwd(Args args) {
    extern __shared__ __attribute__((aligned(16))) unsigned char lds[];
    Frame F;
    F.lds = (LAS unsigned char*)lds;
    F.MISC = (volatile LAS unsigned*)(F.lds + MISC_OFF);
    F.tid = threadIdx.x; F.lane = F.tid & 63; F.wave = __builtin_amdgcn_readfirstlane(F.tid >> 6);
    F.G = gridDim.x; F.bid = blockIdx.x;
    unsigned char* ws = args.ws;
    F.x_p = args.in[0]; F.x_s = args.in[1]; F.c_p = args.in[2]; F.c_s = args.in[3]; F.ck = args.in[4]; F.cv = args.in[5]; F.state = args.in[6];
    F.w_mod = args.in[7]; F.b_mod = args.in[8]; F.g_pre = args.in[9]; F.g_post = args.in[10]; F.w_in = args.in[11]; F.w_a2 = args.in[12]; F.b_a2 = args.in[13];
    F.g_gla = args.in[14]; F.w_out = args.in[15]; F.out = args.out;
    F.WinT = (bf16*)(ws + WS_WINT); F.WoT = (bf16*)(ws + WS_WOT); F.H = (bf16*)(ws + WS_H);
    F.QA = (bf16*)(ws + WS_QA); F.KA = (bf16*)(ws + WS_KA); F.VA = (bf16*)(ws + WS_VA); F.GA = (bf16*)(ws + WS_GA);
    F.QG = (bf16*)(ws + WS_QG); F.KG = (bf16*)(ws + WS_KG); F.VG = (bf16*)(ws + WS_VG); F.GG = (bf16*)(ws + WS_GG);
    F.MIX = (bf16*)(ws + WS_MIX); F.SPREV = (bf16*)(ws + WS_SPREV);
    F.MOD = (float*)(ws + WS_MOD); F.CS = (float*)(ws + WS_CS); F.LA = (float*)(ws + WS_LA); F.QS = (float*)(ws + WS_QS);
    F.SLOC = (float*)(ws + WS_SLOC); F.ACH = (float*)(ws + WS_ACH); F.Y = (float*)(ws + WS_Y);
    for (int u = F.tid; u < (LDS_BYTES - LDSCTL_OFF) / 4; u += NTHR) ((LAS unsigned*)(F.lds + LDSCTL_OFF))[u] = 0u;
    __syncthreads();
    const int lo = args.ph_lo, hi = args.ph_hi;
    const bool multi = !(lo == 0 && hi == 8);
    XcdBarrier bar; bar.bar = (unsigned*)(ws + WS_CTL) + CW_BAR; bar.x = 0; bar.st = nullptr;
    if (!multi) bar = xcd_barrier_post((unsigned*)(ws + WS_CTL) + CW_BAR, F.MISC + 8);
#define IN(k) (lo <= (k) && (k) < hi)
#define GRID_BAR() do { if (!multi) xcd_barrier(bar); } while (0)

    if (IN(0)) { p0_prologue(F); GRID_BAR(); }
    if (IN(1)) { p1_norm(F); GRID_BAR(); }
    if (IN(2)) {
        pg8::Gemm g{F.H, F.WinT, MROWS, NZ, D}; pg8::StaticOrder S; S.init(MROWS, NZ, F.G, F.bid);
        EpiProj E{ws, F.out};
        pg8::gemm_phase<EpiProj, pg8::StaticOrder, true, true>(F.lds, g, S, E);
        GRID_BAR();
    }
    if (IN(3)) {
        p3_gla_local(F);
        p3_gla_sample(F);
        p3_attn_prompt(F);
        p3_attn_sample(F);
        p3_copy(F);
        GRID_BAR();
    }
    if (IN(4)) { p4_gla_scan(F); GRID_BAR(); }
    if (IN(5)) { p5_gla_out(F); GRID_BAR(); }
    if (IN(6)) {
        pg8::Gemm g{F.MIX, F.WoT, MROWS, D, D}; pg8::StaticOrder S; S.init(MROWS, D, F.G, F.bid);
        EpiF32 E{F.Y, D};
        pg8::gemm_phase<EpiF32, pg8::StaticOrder, true, true>(F.lds, g, S, E);
        GRID_BAR();
    }
    if (IN(7)) { p7_final(F); }
#undef IN
#undef GRID_BAR
}

#ifndef MK_N_LAUNCHES
#define MK_N_LAUNCHES 1
#endif
extern "C" void kernel_launch(void* const* d_in, const int* in_sizes, int n_in, void* d_out, int out_size, void* d_ws, size_t ws_size, hipStream_t stream) {
    static int grid = 0;
    if (grid == 0) {
        if (n_in != 16 || (size_t)out_size != O_END || ws_size < WS_END) { fprintf(stderr, "kernel_launch: unexpected shapes (n_in %d, out %d, ws %zu)\n", n_in, out_size, ws_size); grid = -1; return; }
        int dev = 0, cus = 0, per_cu = 0;
        if (hipGetDevice(&dev) != hipSuccess || hipDeviceGetAttribute(&cus, hipDeviceAttributeMultiprocessorCount, dev) != hipSuccess) { grid = -1; return; }
        if (hipFuncSetAttribute((const void*)mk_fwd, hipFuncAttributeMaxDynamicSharedMemorySize, LDS_BYTES) != hipSuccess) { fprintf(stderr, "kernel_launch: hipFuncSetAttribute failed\n"); grid = -1; return; }
        if (hipOccupancyMaxActiveBlocksPerMultiprocessor(&per_cu, (const void*)mk_fwd, NTHR, LDS_BYTES) != hipSuccess || per_cu < 1)
            fprintf(stderr, "kernel_launch: note: occupancy query reports %d workgroups per CU\n", per_cu);
        (void)hipGetLastError();
        grid = cus;
    }
    if (grid < 0) return;
    if (hipMemsetAsync((char*)d_ws + WS_CTL, 0, CTL_ZERO_BYTES, stream) != hipSuccess) { fprintf(stderr, "kernel_launch: memset failed\n"); return; }
    Args a{};
    for (int i = 0; i < 16; ++i) a.in[i] = (const float*)d_in[i];
    a.out = (float*)d_out; a.ws = (unsigned char*)d_ws;
#if MK_N_LAUNCHES == 1
    a.ph_lo = 0; a.ph_hi = 8;
    hipLaunchKernelGGL(mk_fwd, dim3(grid), dim3(NTHR), LDS_BYTES, stream, a);
#else
    for (int p = 0; p < 8; ++p) { a.ph_lo = p; a.ph_hi = p + 1; hipLaunchKernelGGL(mk_fwd, dim3(grid), dim3(NTHR), LDS_BYTES, stream, a); }
#endif
    const hipError_t le = hipPeekAtLastError();
    if (le != hipSuccess) fprintf(stderr, "kernel_launch: launch failed: %s\n", hipGetErrorName(le));
}
```
